# Optimizing an MI355X kernel written in HIP

```python
import jax, jax.numpy as jnp
from jax import lax
import numpy as np

D_MODEL = 1024
BATCH = 8
SEQ = 2048
DEPTH = 2

CHUNK = 128
PLE_DIM = 256
A_HEADS = 8
A_HEAD_DIM = 64
A_WIDTH = A_HEADS * A_HEAD_DIM
B_GROUPS = 4
B_GROUP_DIM = 128
B_WIDTH = B_GROUPS * B_GROUP_DIM
C_GROUPS = 8
C_GROUP_DIM = 64
C_WIDTH = C_GROUPS * C_GROUP_DIM
CONV_WIDTH = 31
N_BRANCHES = 3
LN_EPS = 1e-5
DEEPNORM_ALPHA = (2 * DEPTH) ** 0.25
DEEPNORM_BETA = (8 * DEPTH) ** -0.25
IN_SIZES = (A_WIDTH, A_WIDTH, A_WIDTH, B_WIDTH, B_WIDTH, C_WIDTH, C_WIDTH, C_WIDTH,
            N_BRANCHES * D_MODEL, D_MODEL)
IN_WIDTH = sum(IN_SIZES)

kernel_name = "hybrid_gmlp_fnet_conformer_deepnorm"


def _standardize(x):
    xf = x.astype(jnp.float32)
    mu = jnp.mean(xf, axis=-1, keepdims=True)
    var = jnp.mean(jnp.square(xf - mu), axis=-1, keepdims=True)
    return ((xf - mu) * lax.rsqrt(var + LN_EPS)).astype(x.dtype)


def _layer_norm(x, g, b):
    return _standardize(x) * g + b


def _spatial_gating(u, v, ln_g, ln_b, w_s, b_s):
    u = jax.nn.gelu(u)
    v = _layer_norm(jax.nn.gelu(v), ln_g, ln_b)
    bsz, seq, _ = v.shape
    n_chunks = seq // CHUNK
    vh = v.reshape(bsz, n_chunks, CHUNK, A_HEADS, A_HEAD_DIM)
    mixed = jnp.einsum('hqk,bnkhd->bnqhd', w_s, vh) + jnp.transpose(b_s)[:, :, None]
    return u * mixed.reshape(bsz, seq, A_WIDTH)


def _fourier_mix(z):
    bsz, seq, _ = z.shape
    zg = z.astype(jnp.float32).reshape(bsz, seq, B_GROUPS, B_GROUP_DIM)
    f = jnp.fft.fftn(zg, axes=(1, 3), norm='ortho')
    return jnp.real(f).reshape(bsz, seq, B_WIDTH).astype(z.dtype)


def _conv_module(val, glu_gate, conv_w, conv_b, ln_g, ln_b):
    h = val * jax.nn.sigmoid(glu_gate)
    h = lax.conv_general_dilated(
        h, conv_w[:, None, :].astype(h.dtype), window_strides=(1,), padding='SAME',
        dimension_numbers=('NWC', 'WIO', 'NWC'),
        feature_group_count=C_WIDTH) + conv_b
    bsz, seq, _ = h.shape
    hg = _standardize(h.reshape(bsz, seq, C_GROUPS, C_GROUP_DIM))
    h = hg.reshape(bsz, seq, C_WIDTH) * ln_g + ln_b
    return jax.nn.silu(h)


def _layer(x, p_i, w_in, b_in, a_ln_g, a_ln_b, a_ws, a_bs, c_conv_w, c_conv_b,
           c_ln_g, c_ln_b, w_pa, w_pb, w_pc, w_out, b_out, w_ple, ln_g, ln_b):
    bsz, seq, _ = x.shape
    proj = x @ w_in + b_in
    split_points = [int(s) for s in np.cumsum(IN_SIZES)[:-1]]
    (a_u, a_v, a_g, b_z, b_g, c_val, c_glu, c_g, merge, ple_g) = jnp.split(
        proj, split_points, axis=-1)
    y_a = _spatial_gating(a_u, a_v, a_ln_g, a_ln_b, a_ws, a_bs) * jax.nn.silu(a_g)
    y_b = _fourier_mix(b_z) * jax.nn.silu(b_g)
    y_c = _conv_module(c_val, c_glu, c_conv_w, c_conv_b, c_ln_g, c_ln_b) * jax.nn.silu(c_g)
    gates = jax.nn.sigmoid(merge).reshape(bsz, seq, N_BRANCHES, D_MODEL)
    merged = (gates[:, :, 0] * (y_a @ w_pa)
              + gates[:, :, 1] * (y_b @ w_pb)
              + gates[:, :, 2] * (y_c @ w_pc))
    mix = merged @ w_out + b_out
    ple = jax.nn.sigmoid(ple_g) * (p_i @ w_ple)
    return _layer_norm(DEEPNORM_ALPHA * x + mix + ple, ln_g, ln_b)


def setup_inputs(seed: int = 0) -> dict:
    key = jax.random.key(seed)
    ks = jax.random.split(key, 24)
    f32 = jnp.float32

    def nrm(k, shape, scale):
        return jax.random.normal(k, shape, f32) * scale

    return {
        "x": nrm(ks[0], (BATCH, SEQ, D_MODEL), 1.0),
        "p": nrm(ks[1], (DEPTH, BATCH, SEQ, PLE_DIM), 1.0),
        "w_in": nrm(ks[2], (DEPTH, D_MODEL, IN_WIDTH), D_MODEL ** -0.5),
        "b_in": nrm(ks[3], (DEPTH, IN_WIDTH), 0.02),
        "a_ln_g": 1.0 + nrm(ks[4], (DEPTH, A_WIDTH), 0.02),
        "a_ln_b": nrm(ks[5], (DEPTH, A_WIDTH), 0.02),
        "a_ws": nrm(ks[6], (DEPTH, A_HEADS, CHUNK, CHUNK), CHUNK ** -0.5),
        "a_bs": 1.0 + nrm(ks[7], (DEPTH, A_HEADS, CHUNK), 0.1),
        "c_conv_w": nrm(ks[8], (DEPTH, CONV_WIDTH, C_WIDTH), CONV_WIDTH ** -0.5),
        "c_conv_b": nrm(ks[9], (DEPTH, C_WIDTH), 0.02),
        "c_ln_g": 1.0 + nrm(ks[10], (DEPTH, C_WIDTH), 0.02),
        "c_ln_b": nrm(ks[11], (DEPTH, C_WIDTH), 0.02),
        "w_pa": nrm(ks[12], (DEPTH, A_WIDTH, D_MODEL), DEEPNORM_BETA * A_WIDTH ** -0.5),
        "w_pb": nrm(ks[13], (DEPTH, B_WIDTH, D_MODEL), DEEPNORM_BETA * B_WIDTH ** -0.5),
        "w_pc": nrm(ks[14], (DEPTH, C_WIDTH, D_MODEL), DEEPNORM_BETA * C_WIDTH ** -0.5),
        "w_out": nrm(ks[15], (DEPTH, D_MODEL, D_MODEL), DEEPNORM_BETA * D_MODEL ** -0.5),
        "b_out": nrm(ks[16], (DEPTH, D_MODEL), 0.02),
        "w_ple": nrm(ks[17], (DEPTH, PLE_DIM, D_MODEL), DEEPNORM_BETA * PLE_DIM ** -0.5),
        "ln_g": 1.0 + nrm(ks[18], (DEPTH, D_MODEL), 0.02),
        "ln_b": nrm(ks[19], (DEPTH, D_MODEL), 0.02),
    }


def reference(x, p, w_in, b_in, a_ln_g, a_ln_b, a_ws, a_bs, c_conv_w, c_conv_b,
              c_ln_g, c_ln_b, w_pa, w_pb, w_pc, w_out, b_out, w_ple, ln_g, ln_b):
    for i in range(DEPTH):
        x = _layer(x, p[i], w_in[i], b_in[i], a_ln_g[i], a_ln_b[i], a_ws[i], a_bs[i],
                   c_conv_w[i], c_conv_b[i], c_ln_g[i], c_ln_b[i], w_pa[i], w_pb[i],
                   w_pc[i], w_out[i], b_out[i], w_ple[i], ln_g[i], ln_b[i])
    return x
```

```cpp
#include <hip/hip_runtime.h>
#include <math.h>

namespace {
constexpr int D = 1024, BATCH = 8, SEQ = 2048, DEPTH = 2, M = BATCH * SEQ;
constexpr int CHUNK = 128, PLE = 256, AW = 512, INW = 8192, CONVW = 31;
constexpr float LN_EPS = 1e-5f;
constexpr float ALPHA = 1.41421356237f;
constexpr int O_AU = 0, O_AV = 512, O_AG = 1024, O_BZ = 1536, O_BG = 2048, O_CV = 2560, O_CGLU = 3072, O_CG = 3584, O_MG = 4096, O_PG = 7168;

__device__ __forceinline__ float gelu_t(float x) { return 0.5f * x * (1.f + tanhf(0.7978845608028654f * (x + 0.044715f * x * x * x))); }
__device__ __forceinline__ float sigm(float x) { return 1.f / (1.f + expf(-x)); }
__device__ __forceinline__ float silu(float x) { return x * sigm(x); }

__global__ void __launch_bounds__(256) sgemm_nn(const float* __restrict__ A, int lda, const float* __restrict__ B, int ldb, float* __restrict__ C, int ldc,
                                                const float* __restrict__ bias, int K) {
    __shared__ float As[16][64 + 4];
    __shared__ float Bs[16][64 + 4];
    const int tid = threadIdx.x, tx = tid & 15, ty = tid >> 4;
    const int m0 = blockIdx.y * 64, n0 = blockIdx.x * 64;
    float acc[4][4] = {};
    for (int k0 = 0; k0 < K; k0 += 16) {
        {
            const int r = tid >> 2, c4 = (tid & 3) * 4;
            const float4 v = *(const float4*)(A + (size_t)(m0 + r) * lda + k0 + c4);
            As[c4 + 0][r] = v.x; As[c4 + 1][r] = v.y; As[c4 + 2][r] = v.z; As[c4 + 3][r] = v.w;
            const int kr = tid >> 4, cc = (tid & 15) * 4;
            const float4 w = *(const float4*)(B + (size_t)(k0 + kr) * ldb + n0 + cc);
            Bs[kr][cc + 0] = w.x; Bs[kr][cc + 1] = w.y; Bs[kr][cc + 2] = w.z; Bs[kr][cc + 3] = w.w;
        }
        __syncthreads();
#pragma unroll
        for (int kk = 0; kk < 16; ++kk) {
            float a[4], b[4];
#pragma unroll
            for (int i = 0; i < 4; ++i) { a[i] = As[kk][ty * 4 + i]; b[i] = Bs[kk][tx * 4 + i]; }
#pragma unroll
            for (int i = 0; i < 4; ++i)
#pragma unroll
                for (int j = 0; j < 4; ++j) acc[i][j] = fmaf(a[i], b[j], acc[i][j]);
        }
        __syncthreads();
    }
#pragma unroll
    for (int i = 0; i < 4; ++i)
#pragma unroll
        for (int j = 0; j < 4; ++j) {
            const int n = n0 + tx * 4 + j;
            C[(size_t)(m0 + ty * 4 + i) * ldc + n] = acc[i][j] + (bias ? bias[n] : 0.f);
        }
}

__global__ void k_dft_table(float* __restrict__ F) {
    const size_t i = (size_t)blockIdx.x * blockDim.x + threadIdx.x;
    if (i >= (size_t)SEQ * 2 * SEQ) return;
    const int k = (int)(i / (2 * SEQ)), c = (int)(i % (2 * SEQ));
    const int s = c & (SEQ - 1);
    const int r = (int)(((long long)k * s) & (SEQ - 1));
    const float ang = (float)r * (2.0f / (float)SEQ);
    const float sc = 1.0f / sqrtf((float)SEQ * 128.f);
    F[i] = (c < SEQ ? cospif(ang) : -sinpif(ang)) * sc;
}

__global__ void __launch_bounds__(256) k_a_stats(const float* __restrict__ proj, float* __restrict__ stats) {
    const int tok = blockIdx.x * 4 + (threadIdx.x >> 6), lane = threadIdx.x & 63;
    const float* row = proj + (size_t)tok * INW + O_AV;
    float v[8]; float s = 0.f;
#pragma unroll
    for (int j = 0; j < 8; ++j) { v[j] = gelu_t(row[lane + 64 * j]); s += v[j]; }
    for (int o = 32; o >= 1; o >>= 1) s += __shfl_xor(s, o);
    const float mu = s * (1.f / 512.f); float q = 0.f;
#pragma unroll
    for (int j = 0; j < 8; ++j) { const float d = v[j] - mu; q += d * d; }
    for (int o = 32; o >= 1; o >>= 1) q += __shfl_xor(q, o);
    if (lane == 0) { stats[tok * 2] = mu; stats[tok * 2 + 1] = rsqrtf(q * (1.f / 512.f) + LN_EPS); }
}
__global__ void __launch_bounds__(256) k_a_vln(const float* __restrict__ proj, const float* __restrict__ stats, const float* __restrict__ g, const float* __restrict__ b, float* __restrict__ vln) {
    const int i = blockIdx.x * 256 + threadIdx.x; const int tok = i >> 9, c = i & 511;
    vln[i] = (gelu_t(proj[(size_t)tok * INW + O_AV + c]) - stats[tok * 2]) * stats[tok * 2 + 1] * g[c] + b[c];
}
__global__ void __launch_bounds__(256) k_a_mix(const float* __restrict__ proj, const float* __restrict__ vln, const float* __restrict__ ws, const float* __restrict__ bs, float* __restrict__ ya) {
    const int i = blockIdx.x * 256 + threadIdx.x; const int tok = i >> 9, c = i & 511, h = c >> 6, q = tok & 127, t0 = tok - q;
    const float* w = ws + ((size_t)h * 128 + q) * 128; float acc = 0.f;
    for (int k = 0; k < 128; ++k) acc = fmaf(w[k], vln[(size_t)(t0 + k) * 512 + c], acc);
    acc += bs[h * 128 + q];
    const float* pr = proj + (size_t)tok * INW;
    ya[i] = gelu_t(pr[O_AU + c]) * acc * silu(pr[O_AG + c]);
}
__global__ void __launch_bounds__(256) k_b_chan(const float* __restrict__ proj, float* __restrict__ zcs) {
    const int i = blockIdx.x * 256 + threadIdx.x; const int s = i >> 9, col = i & 511, g = col >> 7, l = col & 127;
    const float* z = proj + (size_t)s * INW + O_BZ + g * 128; float ac = 0.f, as = 0.f;
    for (int c = 0; c < 128; ++c) { const float ang = (float)((c * l) & 127) * (2.f / 128.f); ac = fmaf(z[c], cospif(ang), ac); as = fmaf(z[c], sinpif(ang), as); }
    zcs[(size_t)s * 512 + col] = ac; zcs[(size_t)(SEQ + s) * 512 + col] = as;
}
__global__ void __launch_bounds__(256) k_b_gate(const float* __restrict__ proj, const float* __restrict__ fb, float* __restrict__ yb) {
    const int i = blockIdx.x * 256 + threadIdx.x; const int tok = i >> 9, c = i & 511;
    yb[i] = fb[i] * silu(proj[(size_t)tok * INW + O_BG + c]);
}
__global__ void __launch_bounds__(256) k_c_conv(const float* __restrict__ proj, const float* __restrict__ cw, const float* __restrict__ cb, float* __restrict__ conv) {
    const int i = blockIdx.x * 256 + threadIdx.x; const int t = i >> 9, c = i & 511; float acc = cb[c];
    for (int j = 0; j < CONVW; ++j) { const int tt = t + j - 15; if (tt >= 0 && tt < SEQ) { const float* pr = proj + (size_t)tt * INW; acc = fmaf(pr[O_CV + c] * sigm(pr[O_CGLU + c]), cw[j * 512 + c], acc); } }
    conv[i] = acc;
}
__global__ void __launch_bounds__(256) k_c_norm(const float* __restrict__ proj, const float* __restrict__ conv, const float* __restrict__ g, const float* __restrict__ b, float* __restrict__ yc) {
    const int wg = blockIdx.x * 4 + (threadIdx.x >> 6), lane = threadIdx.x & 63; const int tok = wg >> 3, grp = wg & 7, c = grp * 64 + lane;
    const float v = conv[(size_t)tok * 512 + c]; float s = v;
    for (int o = 32; o >= 1; o >>= 1) s += __shfl_xor(s, o);
    const float mu = s * (1.f / 64.f); const float d = v - mu; float q = d * d;
    for (int o = 32; o >= 1; o >>= 1) q += __shfl_xor(q, o);
    const float hn = d * rsqrtf(q * (1.f / 64.f) + LN_EPS) * g[c] + b[c];
    yc[(size_t)tok * 512 + c] = silu(hn) * silu(proj[(size_t)tok * INW + O_CG + c]);
}
__global__ void __launch_bounds__(256) k_merge(const float* __restrict__ proj, const float* __restrict__ ta, const float* __restrict__ tb, const float* __restrict__ tc, float* __restrict__ merged) {
    const int i = blockIdx.x * 256 + threadIdx.x; const int tok = i >> 10, n = i & 1023; const float* pr = proj + (size_t)tok * INW + O_MG;
    merged[i] = sigm(pr[n]) * ta[i] + sigm(pr[1024 + n]) * tb[i] + sigm(pr[2048 + n]) * tc[i];
}
__global__ void __launch_bounds__(256) k_final(const float* __restrict__ proj, const float* x, const float* __restrict__ mix, const float* __restrict__ plel,
                                               const float* __restrict__ g, const float* __restrict__ b, float* __restrict__ out) {
    __shared__ float red[8];
    const int tok = blockIdx.x, tid = threadIdx.x; float v[4]; float s = 0.f;
#pragma unroll
    for (int j = 0; j < 4; ++j) { const int n = tid + 256 * j; v[j] = ALPHA * x[(size_t)tok * D + n] + mix[(size_t)tok * D + n] + sigm(proj[(size_t)tok * INW + O_PG + n]) * plel[(size_t)tok * D + n]; s += v[j]; }
    for (int o = 32; o >= 1; o >>= 1) s += __shfl_xor(s, o);
    if ((tid & 63) == 0) red[tid >> 6] = s;
    __syncthreads();
    const float mu = (red[0] + red[1] + red[2] + red[3]) * (1.f / 1024.f); float q = 0.f;
#pragma unroll
    for (int j = 0; j < 4; ++j) { const float d = v[j] - mu; q += d * d; }
    for (int o = 32; o >= 1; o >>= 1) q += __shfl_xor(q, o);
    if ((tid & 63) == 0) red[4 + (tid >> 6)] = q;
    __syncthreads();
    const float rstd = rsqrtf((red[4] + red[5] + red[6] + red[7]) * (1.f / 1024.f) + LN_EPS);
#pragma unroll
    for (int j = 0; j < 4; ++j) { const int n = tid + 256 * j; out[(size_t)tok * D + n] = (v[j] - mu) * rstd * g[n] + b[n]; }
}
}

extern "C" void kernel_launch(void* const* d_in, const int* in_sizes, int n_in, void* d_out, int out_size, void* d_ws, size_t ws_size, hipStream_t stream) {
    const float* x = (const float*)d_in[0];     const float* p = (const float*)d_in[1];
    const float* w_in = (const float*)d_in[2];  const float* b_in = (const float*)d_in[3];
    const float* a_ln_g = (const float*)d_in[4]; const float* a_ln_b = (const float*)d_in[5];
    const float* a_ws = (const float*)d_in[6];  const float* a_bs = (const float*)d_in[7];
    const float* c_w = (const float*)d_in[8];   const float* c_b = (const float*)d_in[9];
    const float* c_g = (const float*)d_in[10];  const float* c_bb = (const float*)d_in[11];
    const float* w_pa = (const float*)d_in[12]; const float* w_pb = (const float*)d_in[13]; const float* w_pc = (const float*)d_in[14];
    const float* w_out = (const float*)d_in[15]; const float* b_out = (const float*)d_in[16]; const float* w_ple = (const float*)d_in[17];
    const float* ln_g = (const float*)d_in[18]; const float* ln_b = (const float*)d_in[19];
    float* out = (float*)d_out;
    float* ws = (float*)d_ws; size_t off = 0;
    auto take = [&](size_t n) { float* r = ws + off; off += n; return r; };
    float* proj = take((size_t)SEQ * INW);
    float* F = take((size_t)SEQ * 2 * SEQ);
    float* stats = take(SEQ * 2);
    float* vln = take((size_t)SEQ * 512);
    float* ya = take((size_t)SEQ * 512); float* yb = take((size_t)SEQ * 512); float* yc = take((size_t)SEQ * 512);
    float* zcs = take((size_t)2 * SEQ * 512); float* fb = take((size_t)SEQ * 512); float* conv = take((size_t)SEQ * 512);
    float* ta = take((size_t)SEQ * D); float* tb = take((size_t)SEQ * D); float* tc = take((size_t)SEQ * D);
    float* plel = take((size_t)SEQ * D); float* merged = take((size_t)SEQ * D); float* mix = take((size_t)SEQ * D);
    (void)ws_size; (void)in_sizes; (void)n_in; (void)out_size;

    k_dft_table<<<(SEQ * 2 * SEQ) / 256, 256, 0, stream>>>(F);
    for (int L = 0; L < DEPTH; ++L) {
        const float* Wi = w_in + (size_t)L * D * INW; const float* bi = b_in + (size_t)L * INW;
        for (int bt = 0; bt < BATCH; ++bt) {
            const float* xin = (L == 0 ? x : out) + (size_t)bt * SEQ * D;
            float* xo = out + (size_t)bt * SEQ * D;
            const float* pb = p + ((size_t)L * M + (size_t)bt * SEQ) * PLE;
            sgemm_nn<<<dim3(INW / 64, SEQ / 64), 256, 0, stream>>>(xin, D, Wi, INW, proj, INW, bi, D);
            k_a_stats<<<SEQ / 4, 256, 0, stream>>>(proj, stats);
            k_a_vln<<<SEQ * 512 / 256, 256, 0, stream>>>(proj, stats, a_ln_g + L * 512, a_ln_b + L * 512, vln);
            k_a_mix<<<SEQ * 512 / 256, 256, 0, stream>>>(proj, vln, a_ws + (size_t)L * 8 * 128 * 128, a_bs + L * 8 * 128, ya);
            k_b_chan<<<SEQ * 512 / 256, 256, 0, stream>>>(proj, zcs);
            sgemm_nn<<<dim3(512 / 64, SEQ / 64), 256, 0, stream>>>(F, 2 * SEQ, zcs, 512, fb, 512, nullptr, 2 * SEQ);
            k_b_gate<<<SEQ * 512 / 256, 256, 0, stream>>>(proj, fb, yb);
            k_c_conv<<<SEQ * 512 / 256, 256, 0, stream>>>(proj, c_w + (size_t)L * CONVW * 512, c_b + L * 512, conv);
            k_c_norm<<<SEQ * 8 / 4, 256, 0, stream>>>(proj, conv, c_g + L * 512, c_bb + L * 512, yc);
            sgemm_nn<<<dim3(D / 64, SEQ / 64), 256, 0, stream>>>(ya, 512, w_pa + (size_t)L * 512 * D, D, ta, D, nullptr, 512);
            sgemm_nn<<<dim3(D / 64, SEQ / 64), 256, 0, stream>>>(yb, 512, w_pb + (size_t)L * 512 * D, D, tb, D, nullptr, 512);
            sgemm_nn<<<dim3(D / 64, SEQ / 64), 256, 0, stream>>>(yc, 512, w_pc + (size_t)L * 512 * D, D, tc, D, nullptr, 512);
            sgemm_nn<<<dim3(D / 64, SEQ / 64), 256, 0, stream>>>(pb, PLE, w_ple + (size_t)L * PLE * D, D, plel, D, nullptr, PLE);
            k_merge<<<SEQ * D / 256, 256, 0, stream>>>(proj, ta, tb, tc, merged);
            sgemm_nn<<<dim3(D / 64, SEQ / 64), 256, 0, stream>>>(merged, D, w_out + (size_t)L * D * D, D, mix, D, b_out + L * D, D);
            k_final<<<SEQ, 256, 0, stream>>>(proj, xin, mix, plel, ln_g + L * D, ln_b + L * D, xo);
        }
    }
}
```
